# Optimizing an MI355X kernel written in HIP

```python
import jax, jax.numpy as jnp
from jax import lax
import numpy as np

D_MODEL = 1024
BATCH = 2
SEQ = 8192
DEPTH = 2

GRID_W = 64
CTX_LEN = 256
N_MIXERS = 2
EXPAND = 2
D_INNER = EXPAND * D_MODEL
LRU_BLOCKS = 16
LRU_BLOCK = D_INNER // LRU_BLOCKS
CONV_W = 4
CONV_LEFT = 2
LRU_C = 8.0
POOL_WINDOWS = (2, 4, 8, 16)
N_POOL_GROUPS = len(POOL_WINDOWS)
POOL_GROUP = D_INNER // N_POOL_GROUPS
N_A_LAYERS = (DEPTH + 1) // 2
N_B_LAYERS = DEPTH // 2
ALPHA = float((2 * DEPTH) ** 0.25)
BETA = float((8 * DEPTH) ** -0.25)
LN_EPS = 1e-5

kernel_name = "hybrid_rglru_pool_deepnorm_prefix"


def _layer_norm(v, g, b):
    vf = v.astype(jnp.float32)
    mu = jnp.mean(vf, axis=-1, keepdims=True)
    var = jnp.mean(jnp.square(vf - mu), axis=-1, keepdims=True)
    y = (vf - mu) * lax.rsqrt(var + LN_EPS) * g.astype(jnp.float32) + b.astype(jnp.float32)
    return y.astype(v.dtype)


def _adaln(cvec, w_mod, b_mod):
    m = jax.nn.silu(cvec) @ w_mod + b_mod
    shift, scale, gate = jnp.split(m, 3, axis=-1)
    return shift, scale, gate


def _centred_dwconv(u, w, b):
    L = u.shape[1]
    up = jnp.pad(u, ((0, 0), (CONV_LEFT, CONV_W - 1 - CONV_LEFT), (0, 0)))
    out = up[:, 0:L] * w[0]
    for k in range(1, CONV_W):
        out = out + up[:, k:k + L] * w[k]
    return out + b


def _lru_coeffs(uf, wa, ba, wx, bx, lam):
    bn, L, _ = uf.shape
    ub = uf.reshape(bn, L, LRU_BLOCKS, LRU_BLOCK)
    r = jax.nn.sigmoid(jnp.einsum('blnh,nhk->blnk', ub, wa.astype(jnp.float32)).reshape(bn, L, D_INNER) + ba.astype(jnp.float32))
    i = jax.nn.sigmoid(jnp.einsum('blnh,nhk->blnk', ub, wx.astype(jnp.float32)).reshape(bn, L, D_INNER) + bx.astype(jnp.float32))
    log_a = LRU_C * r * jax.nn.log_sigmoid(lam.astype(jnp.float32))
    a = jnp.exp(log_a)
    drive = jnp.sqrt(-jnp.expm1(2.0 * log_a)) * (i * uf)
    return a, drive


def _linear_scan(a, b, h0, reverse):
    if h0 is not None:
        if reverse:
            b = b.at[:, -1].add(a[:, -1] * h0)
        else:
            b = b.at[:, 0].add(a[:, 0] * h0)

    def combine(left, right):
        a1, b1 = left
        a2, b2 = right
        return a1 * a2, a2 * b1 + b2

    _, h = lax.associative_scan(combine, (a, b), reverse=reverse, axis=1)
    return h


def _rglru(u, wa, ba, wx, bx, lam, h0_f, h0_b):
    uf = u.astype(jnp.float32)
    af, df = _lru_coeffs(uf, wa[0], ba[0], wx[0], bx[0], lam[0])
    ab, db = _lru_coeffs(uf, wa[1], ba[1], wx[1], bx[1], lam[1])
    h_fwd = _linear_scan(af, df, h0_f, False)
    h_bwd = _linear_scan(ab, db, h0_b, True)
    return h_fwd, h_bwd


def _window_mean(v, w, axis):
    n = v.shape[axis]
    cs = jnp.cumsum(v.astype(jnp.float32), axis=axis)
    pad = [(0, 0)] * v.ndim
    pad[axis] = (1, 0)
    cs = jnp.pad(cs, pad)
    t = np.arange(n)
    lo = np.clip(t - w // 2, 0, n)
    hi = np.clip(t + w // 2, 0, n)
    s = jnp.take(cs, hi, axis=axis) - jnp.take(cs, lo, axis=axis)
    cnt_shape = [1] * v.ndim
    cnt_shape[axis] = n
    cnt = jnp.asarray((hi - lo).astype(np.float32)).reshape(cnt_shape)
    return s / cnt


def _pool_grid(u, w_p, scale, rows):
    bn = u.shape[0]
    ug = u.reshape(bn, rows, GRID_W, D_INNER)
    outs = []
    for k, w in enumerate(POOL_WINDOWS):
        seg = ug[..., k * POOL_GROUP:(k + 1) * POOL_GROUP]
        m = _window_mean(_window_mean(seg, w, 2), w, 1)
        d = (m - seg.astype(jnp.float32)).astype(u.dtype)
        outs.append(jnp.einsum('brcg,gh->brch', d, w_p[k]))
    y = jnp.concatenate(outs, axis=-1).reshape(bn, rows * GRID_W, D_INNER)
    return y * scale


def _pool_seq(u, w_p, scale):
    outs = []
    for k, w in enumerate(POOL_WINDOWS):
        seg = u[..., k * POOL_GROUP:(k + 1) * POOL_GROUP]
        d = (_window_mean(seg, w, 1) - seg.astype(jnp.float32)).astype(u.dtype)
        outs.append(jnp.einsum('blg,gh->blh', d, w_p[k]))
    return jnp.concatenate(outs, axis=-1) * scale


def _ctx_needed_after(i):
    return any(j % N_MIXERS == 0 for j in range(i + 1, DEPTH))


def setup_inputs(seed: int = 0) -> dict:
    key = jax.random.key(seed)
    ks = jax.random.split(key, 20)
    f32 = jnp.float32
    x = jax.random.normal(ks[0], (BATCH, SEQ, D_MODEL), f32)
    c = jax.random.normal(ks[1], (BATCH, D_MODEL), f32)
    ctx = jax.random.normal(ks[2], (BATCH, CTX_LEN, D_MODEL), f32)
    c_ctx = jax.random.normal(ks[3], (D_MODEL,), f32)
    w_mod = jax.random.normal(ks[4], (DEPTH, D_MODEL, 3 * D_MODEL), f32) * (0.5 * D_MODEL ** -0.5)
    b_mod = jax.random.normal(ks[5], (DEPTH, 3 * D_MODEL), f32) * 0.02
    w_in = jax.random.normal(ks[6], (DEPTH, D_MODEL, 2 * D_INNER), f32) * D_MODEL ** -0.5
    w_out = jax.random.normal(ks[7], (DEPTH, D_INNER, D_MODEL), f32) * (D_INNER ** -0.5 * BETA)
    ln_g = 1.0 + 0.02 * jax.random.normal(ks[8], (DEPTH, D_MODEL), f32)
    ln_b = 0.02 * jax.random.normal(ks[9], (DEPTH, D_MODEL), f32)
    conv_w = jax.random.normal(ks[10], (N_A_LAYERS, CONV_W, D_INNER), f32) * CONV_W ** -0.5
    conv_b = 0.02 * jax.random.normal(ks[11], (N_A_LAYERS, D_INNER), f32)
    lru_wa = jax.random.normal(ks[12], (N_A_LAYERS, 2, LRU_BLOCKS, LRU_BLOCK, LRU_BLOCK), f32) * LRU_BLOCK ** -0.5
    lru_ba = 0.02 * jax.random.normal(ks[13], (N_A_LAYERS, 2, D_INNER), f32)
    lru_wx = jax.random.normal(ks[14], (N_A_LAYERS, 2, LRU_BLOCKS, LRU_BLOCK, LRU_BLOCK), f32) * LRU_BLOCK ** -0.5
    lru_bx = 0.02 * jax.random.normal(ks[15], (N_A_LAYERS, 2, D_INNER), f32)
    a_pow_c = jax.random.uniform(ks[16], (N_A_LAYERS, 2, D_INNER), f32, minval=0.9, maxval=0.999)
    a0 = a_pow_c ** (1.0 / LRU_C)
    lru_lam = jnp.log(a0) - jnp.log1p(-a0)
    pool_w = jax.random.normal(ks[17], (N_B_LAYERS, N_POOL_GROUPS, POOL_GROUP, POOL_GROUP), f32) * POOL_GROUP ** -0.5
    pool_scale = 1.0 + 0.02 * jax.random.normal(ks[18], (N_B_LAYERS, D_INNER), f32)
    return {"x": x, "c": c, "ctx": ctx, "c_ctx": c_ctx, "w_mod": w_mod, "b_mod": b_mod,
            "w_in": w_in, "w_out": w_out, "ln_g": ln_g, "ln_b": ln_b,
            "conv_w": conv_w, "conv_b": conv_b, "lru_wa": lru_wa, "lru_ba": lru_ba,
            "lru_wx": lru_wx, "lru_bx": lru_bx, "lru_lam": lru_lam,
            "pool_w": pool_w, "pool_scale": pool_scale}


def reference(x, c, ctx, c_ctx, w_mod, b_mod, w_in, w_out, ln_g, ln_b,
              conv_w, conv_b, lru_wa, lru_ba, lru_wx, lru_bx, lru_lam,
              pool_w, pool_scale):
    rows = x.shape[1] // GRID_W
    xc = ctx
    for i in range(DEPTH):
        kind = i % N_MIXERS
        j = i // N_MIXERS
        ctx_out = _ctx_needed_after(i)
        sh, sc, gt = _adaln(c, w_mod[i], b_mod[i])
        h = x * (1.0 + sc[:, None]) + sh[:, None]
        u, g = jnp.split(h @ w_in[i], 2, axis=-1)
        if kind == 0 or ctx_out:
            shc, scc, gtc = _adaln(c_ctx, w_mod[i], b_mod[i])
            hc = xc * (1.0 + scc) + shc
            if ctx_out:
                uc, gc = jnp.split(hc @ w_in[i], 2, axis=-1)
            else:
                uc = hc @ w_in[i][:, :D_INNER]
        if kind == 0:
            uc = _centred_dwconv(uc, conv_w[j], conv_b[j])
            hcf, hcb = _rglru(uc, lru_wa[j], lru_ba[j], lru_wx[j], lru_bx[j], lru_lam[j], None, None)
            u = _centred_dwconv(u, conv_w[j], conv_b[j])
            hf, hb = _rglru(u, lru_wa[j], lru_ba[j], lru_wx[j], lru_bx[j], lru_lam[j],
                            hcf[:, -1], hcb[:, 0])
            y = (hf + hb).astype(x.dtype)
            if ctx_out:
                yc = (hcf + hcb).astype(xc.dtype)
        else:
            y = _pool_grid(u, pool_w[j], pool_scale[j], rows)
            if ctx_out:
                yc = _pool_seq(uc, pool_w[j], pool_scale[j])
        branch = (y * jax.nn.silu(g)) @ w_out[i]
        x = _layer_norm(ALPHA * x + gt[:, None] * branch, ln_g[i], ln_b[i])
        if ctx_out:
            branch_c = (yc * jax.nn.silu(gc)) @ w_out[i]
            xc = _layer_norm(ALPHA * xc + gtc * branch_c, ln_g[i], ln_b[i])
    return x
```

```cpp
#include <hip/hip_runtime.h>
#include <cstdio>
#include <cstdint>

typedef unsigned short bf16;
constexpr int BATCH = 2, SEQ = 8192, DM = 1024, DI = 2048, CTX = 256, GRIDW = 64, GROWS = 128;
constexpr int M = BATCH * SEQ;
constexpr int MC = BATCH * CTX;
constexpr float ALPHA = 1.41421356237f;
constexpr float LN_EPS = 1e-5f;

constexpr size_t MiB = 1u << 20;
constexpr size_t WS_A = 0 * MiB;
constexpr size_t WS_B = 64 * MiB;
constexpr size_t WS_D = 128 * MiB;
constexpr size_t WS_H = 192 * MiB;
constexpr size_t WS_W0T = 224 * MiB;
constexpr size_t WS_W1T = 232 * MiB;
constexpr size_t WS_WO0T = 240 * MiB;
constexpr size_t WS_WO1T = 244 * MiB;
constexpr size_t WS_WGT = 248 * MiB;
constexpr size_t WS_WPT = 250 * MiB;
constexpr size_t WS_UC = 252 * MiB;
constexpr size_t WS_HC = 254 * MiB;
constexpr size_t WS_MODS = 255 * MiB;
constexpr size_t WS_END = 256 * MiB;

__device__ __forceinline__ unsigned f2bf(float f) { unsigned u = __float_as_uint(f); return (u + 0x7fffu + ((u >> 16) & 1u)) >> 16; }
__device__ __forceinline__ float bf2f(bf16 b) { return __uint_as_float(((unsigned)b) << 16); }
__device__ __forceinline__ float silu_f(float v) { return v / (1.0f + __expf(-v)); }
__device__ __forceinline__ float sigmoid_f(float v) { return 1.0f / (1.0f + __expf(-v)); }

__global__ void k_adaln(const float* c, const float* c_ctx, const float* w_mod, const float* b_mod, float* mods) {
    const int n = blockIdx.x * 256 + threadIdx.x, v = blockIdx.y, l = blockIdx.z;
    const float* cv = v < 2 ? c + v * DM : c_ctx;
    const float* W = w_mod + (size_t)l * DM * 3 * DM;
    float acc = 0.f;
    for (int k = 0; k < DM; ++k) acc += silu_f(cv[k]) * W[(size_t)k * 3 * DM + n];
    mods[((size_t)l * 3 + v) * 3 * DM + n] = acc + b_mod[l * 3 * DM + n];
}
__global__ void k_transpose(const float* src, int K, int N, size_t src_bstride, bf16* dst, size_t dst_bstride) {
    __shared__ float t[32][33];
    src += blockIdx.z * src_bstride; dst += blockIdx.z * dst_bstride;
    const int k0 = blockIdx.y * 32, n0 = blockIdx.x * 32, tx = threadIdx.x & 31, ty = threadIdx.x >> 5;
    for (int i = ty; i < 32; i += 8) t[i][tx] = src[(size_t)(k0 + i) * N + n0 + tx];
    __syncthreads();
    for (int i = ty; i < 32; i += 8) dst[(size_t)(n0 + i) * K + k0 + tx] = (bf16)f2bf(t[tx][i]);
}
__global__ void k_modulate(const float* x, const float* mods_l, int rows_per_batch, int vec_fixed, bf16* out, int nrows) {
    const size_t i = (size_t)blockIdx.x * 256 + threadIdx.x;
    if (i >= (size_t)nrows * DM) return;
    const int row = (int)(i / DM), k = (int)(i % DM);
    const int v = vec_fixed >= 0 ? vec_fixed : row / rows_per_batch;
    const float* mv = mods_l + (size_t)v * 3 * DM;
    out[i] = (bf16)f2bf(x[i] * (1.0f + mv[DM + k]) + mv[k]);
}
struct EpiP {
    int mode;
    bf16* o0; bf16* o1; int split; int ldo;
    const float* xin; float* v; const float* mods_l;
    const float* pscale; const bf16* g;
    int a_group_cols;
};
__global__ __launch_bounds__(256) void k_gemm(const bf16* A, int lda, const bf16* Bt, int ldb, int K, EpiP E) {
    __shared__ float As[32][68], Bs[32][68];
    const int tid = threadIdx.x, tx = tid & 15, ty = tid >> 4;
    const int m0 = blockIdx.y * 64, n0 = blockIdx.x * 64;
    const bf16* Ab = A + (size_t)m0 * lda + (E.a_group_cols ? (n0 / E.a_group_cols) * E.a_group_cols : 0);
    const bf16* Bb = Bt + (size_t)n0 * ldb;
    float acc[4][4];
#pragma unroll
    for (int i = 0; i < 4; ++i)
#pragma unroll
        for (int j = 0; j < 4; ++j) acc[i][j] = 0.f;
    const int lr = tid >> 2, lk = (tid & 3) * 8;
    for (int k0 = 0; k0 < K; k0 += 32) {
        const uint4 av = *(const uint4*)(Ab + (size_t)lr * lda + k0 + lk);
        const uint4 bv = *(const uint4*)(Bb + (size_t)lr * ldb + k0 + lk);
        const unsigned aw[4] = {av.x, av.y, av.z, av.w}, bw[4] = {bv.x, bv.y, bv.z, bv.w};
        __syncthreads();
#pragma unroll
        for (int j = 0; j < 4; ++j) {
            As[lk + 2 * j][lr] = __uint_as_float(aw[j] << 16); As[lk + 2 * j + 1][lr] = __uint_as_float(aw[j] & 0xffff0000u);
            Bs[lk + 2 * j][lr] = __uint_as_float(bw[j] << 16); Bs[lk + 2 * j + 1][lr] = __uint_as_float(bw[j] & 0xffff0000u);
        }
        __syncthreads();
#pragma unroll 8
        for (int k = 0; k < 32; ++k) {
            const float4 a = *(const float4*)&As[k][ty * 4], b = *(const float4*)&Bs[k][tx * 4];
            const float ar[4] = {a.x, a.y, a.z, a.w}, br[4] = {b.x, b.y, b.z, b.w};
#pragma unroll
            for (int i = 0; i < 4; ++i)
#pragma unroll
                for (int j = 0; j < 4; ++j) acc[i][j] += ar[i] * br[j];
        }
    }
#pragma unroll
    for (int i = 0; i < 4; ++i)
#pragma unroll
        for (int j = 0; j < 4; ++j) {
            const int row = m0 + ty * 4 + i, col = n0 + tx * 4 + j; const float a = acc[i][j];
            if (E.mode == 0) { if (col < E.split) E.o0[(size_t)row * E.ldo + col] = (bf16)f2bf(a); else E.o1[(size_t)row * E.ldo + col - E.split] = (bf16)f2bf(a); }
            else if (E.mode == 1) { const int b = row / SEQ; const size_t o = (size_t)row * DM + col; E.v[o] = ALPHA * E.xin[o] + E.mods_l[(size_t)b * 3 * DM + 2 * DM + col] * a; }
            else { const size_t o = (size_t)row * DI + col; E.o0[o] = (bf16)f2bf(a * E.pscale[col] * silu_f(bf2f(E.g[o]))); }
        }
}
__global__ __launch_bounds__(128) void k_scan(int dir, const bf16* U, const bf16* UC, const bf16* G, bf16* HF, bf16* Z,
                                              const float* conv_w, const float* conv_b, const float* lru_wa, const float* lru_ba, const float* lru_wx, const float* lru_bx, const float* lru_lam) {
    extern __shared__ float sm[];
    float* Wa = sm; float* Wx = sm + 128 * 128; float* ucs = sm + 2 * 128 * 128;
    const int b = blockIdx.x >> 4, n = blockIdx.x & 15, tid = threadIdx.x, ch = n * 128 + tid;
    const float* wa = lru_wa + ((size_t)dir * 16 + n) * 128 * 128; const float* wx = lru_wx + ((size_t)dir * 16 + n) * 128 * 128;
    for (int i = tid; i < 128 * 128; i += 128) { Wa[i] = wa[i]; Wx[i] = wx[i]; }
    const float cw0 = conv_w[0 * DI + ch], cw1 = conv_w[1 * DI + ch], cw2 = conv_w[2 * DI + ch], cw3 = conv_w[3 * DI + ch], cb = conv_b[ch];
    const float ba = lru_ba[dir * DI + ch], bx = lru_bx[dir * DI + ch];
    const float lam = lru_lam[dir * DI + ch];
    const float L = 8.0f * (fminf(lam, 0.f) - log1pf(expf(-fabsf(lam))));
    float h = 0.f;
    __syncthreads();
    for (int seg = 0; seg < 2; ++seg) {
        const int Ls = seg == 0 ? CTX : SEQ; const bf16* S = seg == 0 ? UC + (size_t)b * CTX * DI : U + (size_t)b * SEQ * DI;
        for (int s = 0; s < Ls; ++s) {
            const int t = dir == 0 ? s : Ls - 1 - s;
            float uc = cb;
            if (t - 2 >= 0) uc += cw0 * bf2f(S[(size_t)(t - 2) * DI + ch]);
            if (t - 1 >= 0) uc += cw1 * bf2f(S[(size_t)(t - 1) * DI + ch]);
            uc += cw2 * bf2f(S[(size_t)t * DI + ch]);
            if (t + 1 < Ls) uc += cw3 * bf2f(S[(size_t)(t + 1) * DI + ch]);
            ucs[tid] = uc;
            __syncthreads();
            float rp = ba, ip = bx;
#pragma unroll 8
            for (int hh = 0; hh < 128; ++hh) { const float uu = ucs[hh]; rp += uu * Wa[hh * 128 + tid]; ip += uu * Wx[hh * 128 + tid]; }
            const float r = sigmoid_f(rp), ig = sigmoid_f(ip);
            const float la = r * L, a = expf(la), dr = sqrtf(-expm1f(2.0f * la)) * (ig * uc);
            h = a * h + dr;
            if (seg == 1) {
                const size_t o = ((size_t)b * SEQ + t) * DI + ch;
                if (dir == 0) HF[o] = (bf16)f2bf(h);
                else Z[o] = (bf16)f2bf((bf2f(HF[o]) + h) * silu_f(bf2f(G[o])));
            }
            __syncthreads();
        }
    }
}
__global__ __launch_bounds__(256) void k_ln(float* V, const float* ln_g, const float* ln_b, const float* mods_next, bf16* Hn) {
    const int row = blockIdx.x * 4 + (threadIdx.x >> 6), lane = threadIdx.x & 63;
    float* vr = V + (size_t)row * DM;
    float v[16]; float s = 0.f;
#pragma unroll
    for (int j = 0; j < 16; ++j) { v[j] = vr[lane + 64 * j]; s += v[j]; }
#pragma unroll
    for (int o = 1; o < 64; o <<= 1) s += __shfl_xor(s, o);
    const float mean = s * (1.0f / DM); float q = 0.f;
#pragma unroll
    for (int j = 0; j < 16; ++j) { const float d = v[j] - mean; q += d * d; }
#pragma unroll
    for (int o = 1; o < 64; o <<= 1) q += __shfl_xor(q, o);
    const float rstd = rsqrtf(q * (1.0f / DM) + LN_EPS);
    const int b = row / SEQ;
#pragma unroll
    for (int j = 0; j < 16; ++j) {
        const int k = lane + 64 * j; const float y = (v[j] - mean) * rstd * ln_g[k] + ln_b[k];
        vr[k] = y;
        if (Hn) { const float* mv = mods_next + (size_t)b * 3 * DM; Hn[(size_t)row * DM + k] = (bf16)f2bf(y * (1.0f + mv[DM + k]) + mv[k]); }
    }
}
__global__ void k_pool(const bf16* U1, bf16* D) {
    const size_t i = (size_t)blockIdx.x * 256 + threadIdx.x;
    const int row = (int)(i / DI), ch = (int)(i % DI);
    const int b = row / SEQ, t = row % SEQ, r = t / GRIDW, c = t % GRIDW;
    const int w = 2 << (ch / 512), hw = w / 2;
    const int rlo = max(r - hw, 0), rhi = min(r + hw, GROWS), clo = max(c - hw, 0), chi = min(c + hw, GRIDW);
    float s = 0.f;
    for (int rr = rlo; rr < rhi; ++rr)
        for (int cc = clo; cc < chi; ++cc) s += bf2f(U1[((size_t)b * SEQ + rr * GRIDW + cc) * DI + ch]);
    const float m = s / (float)((rhi - rlo) * (chi - clo));
    D[i] = (bf16)f2bf(m - bf2f(U1[i]));
}

extern "C" void kernel_launch(void* const* d_in, const int* in_sizes, int n_in, void* d_out, int out_size, void* d_ws, size_t ws_size, hipStream_t stream) {
    static int ok = 0;
    if (ok == 0) {
        if (n_in != 19 || in_sizes[0] != M * DM || out_size != M * DM || ws_size < WS_END) { fprintf(stderr, "kernel_launch: unexpected shapes: n_in %d in0 %d out %d ws %zu\n", n_in, n_in > 0 ? in_sizes[0] : -1, out_size, ws_size); ok = -1; return; }
        if (hipFuncSetAttribute((const void*)k_scan, hipFuncAttributeMaxDynamicSharedMemorySize, (2 * 128 * 128 + 128) * 4) != hipSuccess) { fprintf(stderr, "kernel_launch: hipFuncSetAttribute failed\n"); ok = -1; return; }
        ok = 1;
    }
    if (ok < 0) return;
    const float* x = (const float*)d_in[0]; const float* c = (const float*)d_in[1]; const float* ctx = (const float*)d_in[2]; const float* c_ctx = (const float*)d_in[3];
    const float* w_mod = (const float*)d_in[4]; const float* b_mod = (const float*)d_in[5]; const float* w_in = (const float*)d_in[6]; const float* w_out = (const float*)d_in[7];
    const float* ln_g = (const float*)d_in[8]; const float* ln_b = (const float*)d_in[9]; const float* conv_w = (const float*)d_in[10]; const float* conv_b = (const float*)d_in[11];
    const float* lru_wa = (const float*)d_in[12]; const float* lru_ba = (const float*)d_in[13]; const float* lru_wx = (const float*)d_in[14]; const float* lru_bx = (const float*)d_in[15];
    const float* lru_lam = (const float*)d_in[16]; const float* pool_w = (const float*)d_in[17]; const float* pool_scale = (const float*)d_in[18];
    unsigned char* ws = (unsigned char*)d_ws; float* out = (float*)d_out;
    bf16* RA = (bf16*)(ws + WS_A); bf16* RB = (bf16*)(ws + WS_B); bf16* RD = (bf16*)(ws + WS_D); bf16* H = (bf16*)(ws + WS_H);
    bf16* W0T = (bf16*)(ws + WS_W0T); bf16* W1T = (bf16*)(ws + WS_W1T); bf16* WO0T = (bf16*)(ws + WS_WO0T); bf16* WO1T = (bf16*)(ws + WS_WO1T);
    bf16* WPT = (bf16*)(ws + WS_WPT); bf16* UC = (bf16*)(ws + WS_UC); bf16* HC = (bf16*)(ws + WS_HC); float* MODS = (float*)(ws + WS_MODS);
    bf16* HF = (bf16*)d_out;

    k_adaln<<<dim3(3 * DM / 256, 3, 2), 256, 0, stream>>>(c, c_ctx, w_mod, b_mod, MODS);
    k_transpose<<<dim3(4096 / 32, 1024 / 32, 1), 256, 0, stream>>>(w_in, 1024, 4096, 0, W0T, 0);
    k_transpose<<<dim3(4096 / 32, 1024 / 32, 1), 256, 0, stream>>>(w_in + (size_t)1024 * 4096, 1024, 4096, 0, W1T, 0);
    k_transpose<<<dim3(1024 / 32, 2048 / 32, 1), 256, 0, stream>>>(w_out, 2048, 1024, 0, WO0T, 0);
    k_transpose<<<dim3(1024 / 32, 2048 / 32, 1), 256, 0, stream>>>(w_out + (size_t)2048 * 1024, 2048, 1024, 0, WO1T, 0);
    k_transpose<<<dim3(512 / 32, 512 / 32, 4), 256, 0, stream>>>(pool_w, 512, 512, (size_t)512 * 512, WPT, (size_t)512 * 512);
    k_modulate<<<(M * DM) / 256, 256, 0, stream>>>(x, MODS, SEQ, -1, H, M);
    k_modulate<<<(MC * DM) / 256, 256, 0, stream>>>(ctx, MODS, CTX, 2, HC, MC);
    { EpiP E{}; E.mode = 0; E.o0 = UC; E.o1 = UC; E.split = DI; E.ldo = DI; k_gemm<<<dim3(DI / 64, MC / 64), 256, 0, stream>>>(HC, DM, W0T, DM, DM, E); }
    { EpiP E{}; E.mode = 0; E.o0 = RA; E.o1 = RB; E.split = DI; E.ldo = DI; k_gemm<<<dim3(2 * DI / 64, M / 64), 256, 0, stream>>>(H, DM, W0T, DM, DM, E); }
    k_scan<<<32, 128, (2 * 128 * 128 + 128) * 4, stream>>>(0, RA, UC, RB, HF, RD, conv_w, conv_b, lru_wa, lru_ba, lru_wx, lru_bx, lru_lam);
    k_scan<<<32, 128, (2 * 128 * 128 + 128) * 4, stream>>>(1, RA, UC, RB, HF, RD, conv_w, conv_b, lru_wa, lru_ba, lru_wx, lru_bx, lru_lam);
    { EpiP E{}; E.mode = 1; E.xin = x; E.v = out; E.mods_l = MODS; k_gemm<<<dim3(DM / 64, M / 64), 256, 0, stream>>>(RD, DI, WO0T, DI, DI, E); }
    k_ln<<<M / 4, 256, 0, stream>>>(out, ln_g, ln_b, MODS + (size_t)3 * 3 * DM, H);
    { EpiP E{}; E.mode = 0; E.o0 = RA; E.o1 = RB; E.split = DI; E.ldo = DI; k_gemm<<<dim3(2 * DI / 64, M / 64), 256, 0, stream>>>(H, DM, W1T, DM, DM, E); }
    k_pool<<<(int)(((size_t)M * DI) / 256), 256, 0, stream>>>(RA, RD);
    { EpiP E{}; E.mode = 2; E.o0 = RA; E.pscale = pool_scale; E.g = RB; E.a_group_cols = 512; k_gemm<<<dim3(DI / 64, M / 64), 256, 0, stream>>>(RD, DI, WPT, 512, 512, E); }
    { EpiP E{}; E.mode = 1; E.xin = out; E.v = out; E.mods_l = MODS + (size_t)3 * 3 * DM; k_gemm<<<dim3(DM / 64, M / 64), 256, 0, stream>>>(RA, DI, WO1T, DI, DI, E); }
    k_ln<<<M / 4, 256, 0, stream>>>(out, ln_g + DM, ln_b + DM, nullptr, nullptr);
}
```
